# Optimizing an MI355X kernel written in HIP

```python
import jax, jax.numpy as jnp
from jax import lax
import numpy as np

D_MODEL = 1024
BATCH = 8
SEQ = 2048
DEPTH = 1

CHUNK = 64
GLA_HEADS = 4
GLA_DK = 64
GLA_DV = 128
GLA_QK_W = GLA_HEADS * GLA_DK
GLA_V_W = GLA_HEADS * GLA_DV
GLA_LOWRANK = 16
GLA_GATE_NORM = 16.0
ML_HEADS = 4
ML_DH = 128
ML_W = ML_HEADS * ML_DH
ML_QKV_BLOCK = 4
CONV_K = 4
D_FF = 4 * D_MODEL
EPS = 1e-6
IN_SPLITS = (GLA_QK_W, GLA_QK_W, GLA_V_W, GLA_V_W, GLA_LOWRANK, ML_W, ML_W, D_MODEL, D_MODEL)
D_IN = sum(IN_SPLITS)

kernel_name = "hybrid_gla_mlstm_sandwich_block"


def _rmsnorm(x, g):
    xf = x.astype(jnp.float32)
    y = xf * lax.rsqrt(jnp.mean(xf * xf, axis=-1, keepdims=True) + EPS)
    return (y * g.astype(jnp.float32)).astype(x.dtype)


def _headnorm(x, g):
    xh = x.reshape(*x.shape[:-1], ML_HEADS, ML_DH)
    mu = jnp.mean(xh, axis=-1, keepdims=True)
    var = jnp.mean(jnp.square(xh - mu), axis=-1, keepdims=True)
    y = ((xh - mu) * lax.rsqrt(var + EPS)).reshape(x.shape)
    return y * g.astype(jnp.float32)


def _to_chunks(x, n_heads):
    b, t, w = x.shape
    return x.astype(jnp.float32).reshape(b, t // CHUNK, CHUNK, n_heads, w // n_heads).transpose(0, 3, 1, 2, 4)


def _from_chunks(x):
    b, h, nc, c, d = x.shape
    return x.transpose(0, 2, 3, 1, 4).reshape(b, nc * c, h * d)


def _causal_conv(x, w, bias):
    y = lax.conv_general_dilated(x, w[:, None, :].astype(x.dtype), window_strides=(1,),
                                 padding=[(CONV_K - 1, 0)],
                                 dimension_numbers=('NWC', 'WIO', 'NWC'),
                                 feature_group_count=x.shape[-1])
    return y + bias


def _blockdiag(x, w):
    b, t, n = x.shape
    xb = x.reshape(b, t, n // ML_QKV_BLOCK, ML_QKV_BLOCK)
    return jnp.einsum('btgj,gji->btgi', xb, w).reshape(b, t, n)


def _gla(q, k, v, g, a_low, w_a_up, b_a_up, g_norm):
    b = q.shape[0]
    log_a = jax.nn.log_sigmoid((a_low @ w_a_up + b_a_up).astype(jnp.float32)) / GLA_GATE_NORM
    qc = _to_chunks(q, GLA_HEADS) * GLA_DK ** -0.5
    kc = _to_chunks(k, GLA_HEADS)
    vc = _to_chunks(v, GLA_HEADS)
    cum = jnp.cumsum(_to_chunks(log_a, GLA_HEADS), axis=3)
    e_pos = jnp.exp(cum)
    e_neg = jnp.exp(-cum)
    a_fwd = jnp.einsum('bhntk,bhnsk->bhnts', qc * e_pos, kc * e_neg)
    a_bwd = jnp.einsum('bhntk,bhnsk->bhnts', qc * e_neg, kc * e_pos)
    idx = jnp.arange(CHUNK)
    scores = jnp.where(idx[:, None] >= idx[None, :], a_fwd, a_bwd)
    o = jnp.einsum('bhnts,bhnsv->bhntv', scores, vc)
    cum_last = cum[..., -1:, :]
    s_chunk = jnp.einsum('bhnsk,bhnsv->bhnkv', kc * jnp.exp(cum_last - cum), vc)
    decay = jnp.exp(cum_last[..., 0, :])

    def step(s, inp):
        d, sc = inp
        return d[..., None] * s + sc, s

    s0 = jnp.zeros((b, GLA_HEADS, GLA_DK, GLA_DV), jnp.float32)
    _, s_prev = lax.scan(step, s0, (jnp.moveaxis(decay, 2, 0), jnp.moveaxis(s_chunk, 2, 0)))
    o = o + jnp.einsum('bhntk,bhnkv->bhntv', qc * e_pos, jnp.moveaxis(s_prev, 0, 2))
    o = _rmsnorm(o, g_norm)
    return (_from_chunks(o) * jax.nn.silu(g.astype(jnp.float32))).astype(q.dtype)


def _mlstm(x_m, o_pre, conv_w, conv_b, w_q, w_k, w_v, w_if, b_if, skip, g_norm):
    b, t, _ = x_m.shape
    nc = t // CHUNK
    xc = jax.nn.silu(_causal_conv(x_m, conv_w, conv_b))
    q = _blockdiag(xc, w_q)
    k = _blockdiag(xc, w_k)
    v = _blockdiag(x_m, w_v)
    gates = (jnp.concatenate([q, k, v], axis=-1) @ w_if + b_if).astype(jnp.float32)
    gates = gates.reshape(b, nc, CHUNK, 2 * ML_HEADS).transpose(0, 3, 1, 2)
    log_i = gates[:, :ML_HEADS]
    log_f = jax.nn.log_sigmoid(gates[:, ML_HEADS:])
    f_cum = jnp.cumsum(log_f, axis=-1)
    qc = _to_chunks(q, ML_HEADS)
    kc = _to_chunks(k, ML_HEADS) * ML_DH ** -0.5
    vc = _to_chunks(v, ML_HEADS)
    f_last = f_cum[..., -1]
    a = f_last[..., None] - f_cum + log_i
    m_loc = jnp.max(a, axis=-1)
    kw = kc * jnp.exp(a - m_loc[..., None])[..., None]
    c_chunk = jnp.einsum('bhnsk,bhnsv->bhnkv', kw, vc)
    n_chunk = jnp.sum(kw, axis=3)

    def step(carry, inp):
        c, n, m = carry
        fl, ml, cc, ncnk = inp
        m_new = jnp.maximum(fl + m, ml)
        sp = jnp.exp(fl + m - m_new)
        sl = jnp.exp(ml - m_new)
        c_new = sp[..., None, None] * c + sl[..., None, None] * cc
        n_new = sp[..., None] * n + sl[..., None] * ncnk
        return (c_new, n_new, m_new), (c, n, m)

    init = (jnp.zeros((b, ML_HEADS, ML_DH, ML_DH), jnp.float32),
            jnp.zeros((b, ML_HEADS, ML_DH), jnp.float32),
            jnp.zeros((b, ML_HEADS), jnp.float32))
    xs = (jnp.moveaxis(f_last, 2, 0), jnp.moveaxis(m_loc, 2, 0),
          jnp.moveaxis(c_chunk, 2, 0), jnp.moveaxis(n_chunk, 2, 0))
    _, (c_prev, n_prev, m_prev) = lax.scan(step, init, xs)
    c_prev = jnp.moveaxis(c_prev, 0, 2)
    n_prev = jnp.moveaxis(n_prev, 0, 2)
    m_prev = jnp.moveaxis(m_prev, 0, 2)
    log_d = log_i[..., None, :] - jnp.abs(f_cum[..., :, None] - f_cum[..., None, :])
    g_inter = f_cum + m_prev[..., None]
    m_t = jnp.maximum(g_inter, jnp.max(log_d, axis=-1))
    s = jnp.einsum('bhntk,bhnsk->bhnts', qc, kc) * jnp.exp(log_d - m_t[..., None])
    sc = jnp.exp(g_inter - m_t)
    num = jnp.einsum('bhnts,bhnsv->bhntv', s, vc) + sc[..., None] * jnp.einsum('bhntk,bhnkv->bhntv', qc, c_prev)
    den = jnp.sum(s, axis=-1) + sc * jnp.einsum('bhntk,bhnk->bhnt', qc, n_prev)
    den = jnp.maximum(jnp.abs(den), jnp.exp(-m_t))
    h_cell = _from_chunks(num / den[..., None]) * jax.nn.sigmoid(o_pre.astype(jnp.float32))
    h = _headnorm(h_cell, g_norm) + skip.astype(jnp.float32) * xc.astype(jnp.float32)
    return h.astype(x_m.dtype)


def setup_inputs(seed: int = 0) -> dict:
    key = jax.random.key(seed)
    ks = jax.random.split(key, 24)
    L = DEPTH

    def nrm(k, shape, scale):
        return jax.random.normal(k, shape, jnp.float32) * scale

    def gain(k, n):
        return 1.0 + nrm(k, (L, n), 0.02)

    bi = nrm(ks[12], (L, 2 * ML_HEADS), 0.1)
    b_if = jnp.concatenate([bi[:, :ML_HEADS], jnp.linspace(3.0, 6.0, ML_HEADS)[None, :] + bi[:, ML_HEADS:]], axis=-1)
    return {
        "x": nrm(ks[0], (BATCH, SEQ, D_MODEL), 1.0),
        "g_pre_mix": gain(ks[1], D_MODEL),
        "w_in": nrm(ks[2], (L, D_MODEL, D_IN), D_MODEL ** -0.5),
        "w_a_up": nrm(ks[3], (L, GLA_LOWRANK, GLA_QK_W), GLA_LOWRANK ** -0.5),
        "b_a_up": nrm(ks[4], (L, GLA_QK_W), 0.1),
        "g_gla_norm": gain(ks[5], GLA_DV),
        "conv_w": nrm(ks[6], (L, CONV_K, ML_W), CONV_K ** -0.5),
        "conv_b": nrm(ks[7], (L, ML_W), 0.02),
        "w_q_ml": nrm(ks[8], (L, ML_W // ML_QKV_BLOCK, ML_QKV_BLOCK, ML_QKV_BLOCK), ML_QKV_BLOCK ** -0.5),
        "w_k_ml": nrm(ks[9], (L, ML_W // ML_QKV_BLOCK, ML_QKV_BLOCK, ML_QKV_BLOCK), ML_QKV_BLOCK ** -0.5),
        "w_v_ml": nrm(ks[10], (L, ML_W // ML_QKV_BLOCK, ML_QKV_BLOCK, ML_QKV_BLOCK), ML_QKV_BLOCK ** -0.5),
        "w_if": nrm(ks[11], (L, 3 * ML_W, 2 * ML_HEADS), (3 * ML_W) ** -0.5),
        "b_if": b_if,
        "ml_skip": gain(ks[13], ML_W),
        "g_ml_norm": gain(ks[14], ML_W),
        "w_pa": nrm(ks[15], (L, GLA_V_W, D_MODEL), GLA_V_W ** -0.5),
        "w_pb": nrm(ks[16], (L, ML_W, D_MODEL), ML_W ** -0.5),
        "w_o": nrm(ks[17], (L, D_MODEL, D_MODEL), D_MODEL ** -0.5),
        "g_post_mix": gain(ks[18], D_MODEL),
        "g_pre_mlp": gain(ks[19], D_MODEL),
        "w_up": nrm(ks[20], (L, D_MODEL, D_FF), D_MODEL ** -0.5),
        "w_down": nrm(ks[21], (L, D_FF, D_MODEL), D_FF ** -0.5),
        "g_post_mlp": gain(ks[22], D_MODEL),
    }


def reference(x, g_pre_mix, w_in, w_a_up, b_a_up, g_gla_norm, conv_w, conv_b, w_q_ml, w_k_ml, w_v_ml,
              w_if, b_if, ml_skip, g_ml_norm, w_pa, w_pb, w_o, g_post_mix, g_pre_mlp, w_up, w_down,
              g_post_mlp):
    split_at = [int(s) for s in np.cumsum(IN_SPLITS)[:-1]]
    for l in range(DEPTH):
        h = _rmsnorm(x, g_pre_mix[l])
        proj = h @ w_in[l]
        q_a, k_a, v_a, g_a, a_low, x_m, o_pre, gate_a, gate_b = jnp.split(proj, split_at, axis=-1)
        y_a = _gla(q_a, k_a, v_a, g_a, a_low, w_a_up[l], b_a_up[l], g_gla_norm[l]) @ w_pa[l]
        y_b = _mlstm(x_m, o_pre, conv_w[l], conv_b[l], w_q_ml[l], w_k_ml[l], w_v_ml[l],
                     w_if[l], b_if[l], ml_skip[l], g_ml_norm[l]) @ w_pb[l]
        merged = jax.nn.sigmoid(gate_a) * y_a + jax.nn.sigmoid(gate_b) * y_b
        x = x + _rmsnorm(merged @ w_o[l], g_post_mix[l])
        h2 = _rmsnorm(x, g_pre_mlp[l])
        u = jnp.square(jax.nn.relu(h2 @ w_up[l]))
        x = x + _rmsnorm(u @ w_down[l], g_post_mlp[l])
    return x
```

```cpp
#include <hip/hip_runtime.h>
#include <cstdio>
#include <cstdint>

namespace {
constexpr int D = 1024, NB = 8, T = 2048, CH = 64, NCH = T / CH, DIN = 4624, FF = 4096;
constexpr int O_QA = 0, O_KA = 256, O_VA = 512, O_GA = 1024, O_AL = 1536, O_XM = 1552, O_OP = 2064, O_GTA = 2576, O_GTB = 3600;
constexpr float EPS = 1e-6f;

__device__ __forceinline__ float sigmoidf_(float x) { return 1.f / (1.f + expf(-x)); }
__device__ __forceinline__ float siluf_(float x) { return x * sigmoidf_(x); }
__device__ __forceinline__ float logsigf_(float x) { return fminf(x, 0.f) - log1pf(expf(-fabsf(x))); }

__device__ __forceinline__ float block_sum256(float v, float* red) {
    for (int o = 32; o > 0; o >>= 1) v += __shfl_xor(v, o);
    __syncthreads();
    if ((threadIdx.x & 63) == 0) red[threadIdx.x >> 6] = v;
    __syncthreads();
    return red[0] + red[1] + red[2] + red[3];
}

__global__ void __launch_bounds__(256) k_rmsnorm(const float* __restrict__ x, const float* __restrict__ g, float* __restrict__ y) {
    __shared__ float red[4];
    const size_t row = blockIdx.x;
    float v[4]; float s = 0.f;
#pragma unroll
    for (int i = 0; i < 4; ++i) { v[i] = x[row * D + threadIdx.x + 256 * i]; s += v[i] * v[i]; }
    const float tot = block_sum256(s, red);
    const float r = rsqrtf(tot * (1.f / D) + EPS);
#pragma unroll
    for (int i = 0; i < 4; ++i) y[row * D + threadIdx.x + 256 * i] = v[i] * r * g[threadIdx.x + 256 * i];
}

__global__ void __launch_bounds__(256) k_gemm(const float* __restrict__ A, int lda, const float* __restrict__ Bm, int ldb, float* __restrict__ C, int ldc, int N, int K, int act) {
    __shared__ float As[16][68];
    __shared__ float Bs[16][68];
    const int tx = threadIdx.x & 15, ty = threadIdx.x >> 4;
    const int m0 = blockIdx.y * 64, n0 = blockIdx.x * 64;
    float acc[4][4];
#pragma unroll
    for (int i = 0; i < 4; ++i)
#pragma unroll
        for (int j = 0; j < 4; ++j) acc[i][j] = 0.f;
    for (int k0 = 0; k0 < K; k0 += 16) {
#pragma unroll
        for (int r = 0; r < 4; ++r) { const int i = threadIdx.x + 256 * r; const int m = i >> 4, k = i & 15; As[k][m] = A[(size_t)(m0 + m) * lda + k0 + k]; }
#pragma unroll
        for (int r = 0; r < 4; ++r) { const int i = threadIdx.x + 256 * r; const int k = i >> 6, n = i & 63; Bs[k][n] = (n0 + n < N) ? Bm[(size_t)(k0 + k) * ldb + n0 + n] : 0.f; }
        __syncthreads();
#pragma unroll
        for (int k = 0; k < 16; ++k) {
            float a[4], b[4];
#pragma unroll
            for (int i = 0; i < 4; ++i) { a[i] = As[k][ty * 4 + i]; b[i] = Bs[k][tx * 4 + i]; }
#pragma unroll
            for (int i = 0; i < 4; ++i)
#pragma unroll
                for (int j = 0; j < 4; ++j) acc[i][j] = fmaf(a[i], b[j], acc[i][j]);
        }
        __syncthreads();
    }
#pragma unroll
    for (int i = 0; i < 4; ++i)
#pragma unroll
        for (int j = 0; j < 4; ++j) {
            const int n = n0 + tx * 4 + j;
            if (n < N) { float v = acc[i][j]; if (act == 1) { v = fmaxf(v, 0.f); v = v * v; } C[(size_t)(m0 + ty * 4 + i) * ldc + n] = v; }
        }
}

__global__ void __launch_bounds__(256) k_gla_cum(const float* __restrict__ proj, const float* __restrict__ w_a_up, const float* __restrict__ b_a_up, float* __restrict__ cum) {
    const int col = threadIdx.x, chunk = blockIdx.x;
    float w[16];
#pragma unroll
    for (int j = 0; j < 16; ++j) w[j] = w_a_up[j * 256 + col];
    const float bb = b_a_up[col];
    float run = 0.f;
    for (int s = 0; s < CH; ++s) {
        const int t = chunk * CH + s;
        float z = 0.f;
#pragma unroll
        for (int j = 0; j < 16; ++j) z = fmaf(proj[(size_t)t * DIN + O_AL + j], w[j], z);
        z += bb;
        run += logsigf_(z) * (1.f / 16.f);
        cum[(size_t)t * 256 + col] = run;
    }
}
__global__ void __launch_bounds__(256) k_gla_state(const float* __restrict__ proj, const float* __restrict__ cum, float* __restrict__ sc, float* __restrict__ dec) {
    const int h = blockIdx.y, chunk = blockIdx.x, t0 = chunk * CH;
    __shared__ float kd[CH][65];
    for (int i = threadIdx.x; i < CH * 64; i += 256) {
        const int s = i >> 6, k = i & 63;
        const float cl = cum[(size_t)(t0 + CH - 1) * 256 + h * 64 + k], c = cum[(size_t)(t0 + s) * 256 + h * 64 + k];
        kd[s][k] = proj[(size_t)(t0 + s) * DIN + O_KA + h * 64 + k] * expf(cl - c);
    }
    if (threadIdx.x < 64) dec[(h * NCH + chunk) * 64 + threadIdx.x] = expf(cum[(size_t)(t0 + CH - 1) * 256 + h * 64 + threadIdx.x]);
    __syncthreads();
    float* out = sc + (size_t)(h * NCH + chunk) * 64 * 128;
    for (int e = threadIdx.x; e < 64 * 128; e += 256) {
        const int k = e >> 7, v = e & 127;
        float a = 0.f;
        for (int s = 0; s < CH; ++s) a = fmaf(kd[s][k], proj[(size_t)(t0 + s) * DIN + O_VA + h * 128 + v], a);
        out[e] = a;
    }
}
__global__ void __launch_bounds__(256) k_gla_scan(const float* __restrict__ sc, const float* __restrict__ dec, float* __restrict__ sprev) {
    const int idx = blockIdx.x * 256 + threadIdx.x;
    const int h = idx >> 13, e = idx & 8191, k = e >> 7;
    float s = 0.f;
    for (int n = 0; n < NCH; ++n) {
        const size_t o = (size_t)(h * NCH + n) * 8192 + e;
        sprev[o] = s;
        s = dec[(h * NCH + n) * 64 + k] * s + sc[o];
    }
}
__global__ void __launch_bounds__(256) k_gla_out(const float* __restrict__ proj, const float* __restrict__ cum, const float* __restrict__ sprev, const float* __restrict__ g_norm, float* __restrict__ Aa) {
    const int h = blockIdx.y, chunk = blockIdx.x, t0 = chunk * CH;
    __shared__ float sco[CH][65];
    __shared__ float o[CH][129];
    __shared__ float rs[CH];
    for (int i = threadIdx.x; i < CH * CH; i += 256) {
        const int t = i >> 6, s = i & 63;
        float a = 0.f;
        for (int k = 0; k < 64; ++k) {
            const float ct = cum[(size_t)(t0 + t) * 256 + h * 64 + k], cs = cum[(size_t)(t0 + s) * 256 + h * 64 + k];
            const float dcy = (t >= s) ? expf(ct - cs) : expf(cs - ct);
            a = fmaf(proj[(size_t)(t0 + t) * DIN + O_QA + h * 64 + k] * 0.125f * dcy, proj[(size_t)(t0 + s) * DIN + O_KA + h * 64 + k], a);
        }
        sco[t][s] = a;
    }
    __syncthreads();
    const float* sp = sprev + (size_t)(h * NCH + chunk) * 8192;
    for (int e = threadIdx.x; e < CH * 128; e += 256) {
        const int t = e >> 7, v = e & 127;
        float a = 0.f;
        for (int s = 0; s < CH; ++s) a = fmaf(sco[t][s], proj[(size_t)(t0 + s) * DIN + O_VA + h * 128 + v], a);
        for (int k = 0; k < 64; ++k) {
            const float qf = proj[(size_t)(t0 + t) * DIN + O_QA + h * 64 + k] * 0.125f * expf(cum[(size_t)(t0 + t) * 256 + h * 64 + k]);
            a = fmaf(qf, sp[k * 128 + v], a);
        }
        o[t][v] = a;
    }
    __syncthreads();
    if (threadIdx.x < CH) { float s = 0.f; for (int v = 0; v < 128; ++v) s += o[threadIdx.x][v] * o[threadIdx.x][v]; rs[threadIdx.x] = rsqrtf(s * (1.f / 128.f) + EPS); }
    __syncthreads();
    for (int e = threadIdx.x; e < CH * 128; e += 256) {
        const int t = e >> 7, v = e & 127;
        const float g = proj[(size_t)(t0 + t) * DIN + O_GA + h * 128 + v];
        Aa[(size_t)(t0 + t) * 512 + h * 128 + v] = o[t][v] * rs[t] * g_norm[v] * siluf_(g);
    }
}

__global__ void __launch_bounds__(128) k_ml_pre(const float* __restrict__ proj, const float* __restrict__ conv_w, const float* __restrict__ conv_b,
                                                const float* __restrict__ w_q, const float* __restrict__ w_k, const float* __restrict__ w_v,
                                                float* __restrict__ xc, float* __restrict__ q, float* __restrict__ k, float* __restrict__ v) {
    const int t = blockIdx.x, g = threadIdx.x;
    float xcj[4], xmj[4];
#pragma unroll
    for (int j = 0; j < 4; ++j) {
        const int c = 4 * g + j;
        float a = conv_b[c];
#pragma unroll
        for (int i = 0; i < 4; ++i) { const int tt = t - 3 + i; if (tt >= 0) a = fmaf(conv_w[i * 512 + c], proj[(size_t)tt * DIN + O_XM + c], a); }
        xcj[j] = siluf_(a);
        xmj[j] = proj[(size_t)t * DIN + O_XM + c];
        xc[(size_t)t * 512 + c] = xcj[j];
    }
#pragma unroll
    for (int i = 0; i < 4; ++i) {
        float aq = 0.f, ak = 0.f, av = 0.f;
#pragma unroll
        for (int j = 0; j < 4; ++j) { aq = fmaf(xcj[j], w_q[(g * 4 + j) * 4 + i], aq); ak = fmaf(xcj[j], w_k[(g * 4 + j) * 4 + i], ak); av = fmaf(xmj[j], w_v[(g * 4 + j) * 4 + i], av); }
        q[(size_t)t * 512 + 4 * g + i] = aq; k[(size_t)t * 512 + 4 * g + i] = ak; v[(size_t)t * 512 + 4 * g + i] = av;
    }
}
__global__ void __launch_bounds__(256) k_ml_gates(const float* __restrict__ q, const float* __restrict__ k, const float* __restrict__ v, const float* __restrict__ w_if, const float* __restrict__ b_if,
                                                  float* __restrict__ li, float* __restrict__ lf) {
    const int t = blockIdx.x * 4 + (threadIdx.x >> 6), lane = threadIdx.x & 63;
    float a[8];
#pragma unroll
    for (int j = 0; j < 8; ++j) a[j] = 0.f;
    for (int c = lane; c < 1536; c += 64) {
        const float val = (c < 512) ? q[(size_t)t * 512 + c] : (c < 1024 ? k[(size_t)t * 512 + c - 512] : v[(size_t)t * 512 + c - 1024]);
#pragma unroll
        for (int j = 0; j < 8; ++j) a[j] = fmaf(val, w_if[c * 8 + j], a[j]);
    }
#pragma unroll
    for (int j = 0; j < 8; ++j) { for (int o = 32; o > 0; o >>= 1) a[j] += __shfl_xor(a[j], o); }
    if (lane == 0) {
#pragma unroll
        for (int j = 0; j < 4; ++j) { li[t * 4 + j] = a[j] + b_if[j]; lf[t * 4 + j] = logsigf_(a[4 + j] + b_if[4 + j]); }
    }
}
__global__ void k_ml_cum(const float* __restrict__ li, const float* __restrict__ lf, float* __restrict__ fcum, float* __restrict__ flast, float* __restrict__ mloc) {
    const int idx = blockIdx.x * blockDim.x + threadIdx.x; if (idx >= 4 * NCH) return;
    const int h = idx / NCH, chunk = idx % NCH, t0 = chunk * CH;
    float run = 0.f;
    for (int s = 0; s < CH; ++s) { run += lf[(t0 + s) * 4 + h]; fcum[(t0 + s) * 4 + h] = run; }
    float m = -INFINITY;
    for (int s = 0; s < CH; ++s) m = fmaxf(m, run - fcum[(t0 + s) * 4 + h] + li[(t0 + s) * 4 + h]);
    flast[idx] = run; mloc[idx] = m;
}
__global__ void __launch_bounds__(256) k_ml_state(const float* __restrict__ kk, const float* __restrict__ vv, const float* __restrict__ li, const float* __restrict__ fcum,
                                                  const float* __restrict__ flast, const float* __restrict__ mloc, float* __restrict__ cc, float* __restrict__ ncn) {
    const int h = blockIdx.y, chunk = blockIdx.x, t0 = chunk * CH, u = h * NCH + chunk;
    __shared__ float w[CH];
    if (threadIdx.x < CH) { const int s = threadIdx.x; w[s] = expf(flast[u] - fcum[(t0 + s) * 4 + h] + li[(t0 + s) * 4 + h] - mloc[u]) * 0.08838834764831845f; }
    __syncthreads();
    for (int e = threadIdx.x; e < 128 * 128; e += 256) {
        const int k = e >> 7, v = e & 127;
        float a = 0.f, n = 0.f;
        for (int s = 0; s < CH; ++s) { const float kw = kk[(size_t)(t0 + s) * 512 + h * 128 + k] * w[s]; a = fmaf(kw, vv[(size_t)(t0 + s) * 512 + h * 128 + v], a); n += kw; }
        cc[(size_t)u * 16384 + e] = a;
        if (v == 0) ncn[u * 128 + k] = n;
    }
}
__global__ void __launch_bounds__(256) k_ml_scan(const float* __restrict__ cc, const float* __restrict__ ncn, const float* __restrict__ flast, const float* __restrict__ mloc,
                                                 float* __restrict__ cprev, float* __restrict__ nprev, float* __restrict__ mprev) {
    const int idx = blockIdx.x * 256 + threadIdx.x;
    const int h = idx >> 14, e = idx & 16383, k = e >> 7, v = e & 127;
    float c = 0.f, n = 0.f, m = 0.f;
    for (int ch = 0; ch < NCH; ++ch) {
        const int u = h * NCH + ch;
        cprev[(size_t)u * 16384 + e] = c;
        if (v == 0) nprev[u * 128 + k] = n;
        if (e == 0) mprev[u] = m;
        const float fl = flast[u], ml = mloc[u];
        const float mn = fmaxf(fl + m, ml);
        const float sp = expf(fl + m - mn), sl = expf(ml - mn);
        c = sp * c + sl * cc[(size_t)u * 16384 + e];
        n = sp * n + sl * ncn[u * 128 + k];
        m = mn;
    }
}
__global__ void __launch_bounds__(256) k_ml_out(const float* __restrict__ proj, const float* __restrict__ qq, const float* __restrict__ kk, const float* __restrict__ vv, const float* __restrict__ xc,
                                                const float* __restrict__ li, const float* __restrict__ fcum, const float* __restrict__ cprev, const float* __restrict__ nprev, const float* __restrict__ mprev,
                                                const float* __restrict__ skip, const float* __restrict__ g_norm, float* __restrict__ Ab) {
    const int h = blockIdx.y, chunk = blockIdx.x, t0 = chunk * CH, u = h * NCH + chunk;
    __shared__ float S[CH][65];
    __shared__ float o[CH][129];
    __shared__ float s_li[CH], s_fc[CH], s_mt[CH], s_sc[CH], s_den[CH], s_mu[CH], s_rs[CH];
    if (threadIdx.x < CH) { s_li[threadIdx.x] = li[(t0 + threadIdx.x) * 4 + h]; s_fc[threadIdx.x] = fcum[(t0 + threadIdx.x) * 4 + h]; }
    __syncthreads();
    const float mp = mprev[u];
    if (threadIdx.x < CH) {
        const int t = threadIdx.x;
        const float gi = s_fc[t] + mp;
        float mx = -INFINITY;
        for (int s = 0; s < CH; ++s) mx = fmaxf(mx, s_li[s] - fabsf(s_fc[t] - s_fc[s]));
        const float mt = fmaxf(gi, mx);
        s_mt[t] = mt; s_sc[t] = expf(gi - mt);
    }
    __syncthreads();
    for (int i = threadIdx.x; i < CH * CH; i += 256) {
        const int t = i >> 6, s = i & 63;
        float a = 0.f;
        for (int k = 0; k < 128; ++k) a = fmaf(qq[(size_t)(t0 + t) * 512 + h * 128 + k], kk[(size_t)(t0 + s) * 512 + h * 128 + k], a);
        S[t][s] = a * 0.08838834764831845f * expf(s_li[s] - fabsf(s_fc[t] - s_fc[s]) - s_mt[t]);
    }
    __syncthreads();
    if (threadIdx.x < CH) {
        const int t = threadIdx.x;
        float d = 0.f;
        for (int s = 0; s < CH; ++s) d += S[t][s];
        float qn = 0.f;
        for (int k = 0; k < 128; ++k) qn = fmaf(qq[(size_t)(t0 + t) * 512 + h * 128 + k], nprev[u * 128 + k], qn);
        d += s_sc[t] * qn;
        s_den[t] = fmaxf(fabsf(d), expf(-s_mt[t]));
    }
    const float* cp = cprev + (size_t)u * 16384;
    for (int e = threadIdx.x; e < CH * 128; e += 256) {
        const int t = e >> 7, v = e & 127;
        float a = 0.f;
        for (int s = 0; s < CH; ++s) a = fmaf(S[t][s], vv[(size_t)(t0 + s) * 512 + h * 128 + v], a);
        float b = 0.f;
        for (int k = 0; k < 128; ++k) b = fmaf(qq[(size_t)(t0 + t) * 512 + h * 128 + k], cp[k * 128 + v], b);
        o[t][v] = a + s_sc[t] * b;
    }
    __syncthreads();
    for (int e = threadIdx.x; e < CH * 128; e += 256) {
        const int t = e >> 7, v = e & 127;
        o[t][v] = o[t][v] / s_den[t] * sigmoidf_(proj[(size_t)(t0 + t) * DIN + O_OP + h * 128 + v]);
    }
    __syncthreads();
    if (threadIdx.x < CH) {
        const int t = threadIdx.x;
        float mu = 0.f; for (int v = 0; v < 128; ++v) mu += o[t][v]; mu *= (1.f / 128.f);
        float var = 0.f; for (int v = 0; v < 128; ++v) { const float d = o[t][v] - mu; var += d * d; } var *= (1.f / 128.f);
        s_mu[t] = mu; s_rs[t] = rsqrtf(var + EPS);
    }
    __syncthreads();
    for (int e = threadIdx.x; e < CH * 128; e += 256) {
        const int t = e >> 7, v = e & 127, c = h * 128 + v;
        Ab[(size_t)(t0 + t) * 512 + c] = (o[t][v] - s_mu[t]) * s_rs[t] * g_norm[c] + skip[c] * xc[(size_t)(t0 + t) * 512 + c];
    }
}

__global__ void __launch_bounds__(256) k_merge(const float* __restrict__ proj, float* __restrict__ ya, const float* __restrict__ yb) {
    const size_t row = blockIdx.x;
#pragma unroll
    for (int i = 0; i < 4; ++i) {
        const int c = threadIdx.x + 256 * i;
        ya[row * D + c] = sigmoidf_(proj[row * DIN + O_GTA + c]) * ya[row * D + c] + sigmoidf_(proj[row * DIN + O_GTB + c]) * yb[row * D + c];
    }
}
__global__ void __launch_bounds__(256) k_res_norm2(const float* __restrict__ x, const float* __restrict__ mix, const float* __restrict__ g1, const float* __restrict__ g2, float* __restrict__ x1, float* __restrict__ h2) {
    __shared__ float red[4];
    const size_t row = blockIdx.x;
    float m[4], xv[4]; float s = 0.f;
#pragma unroll
    for (int i = 0; i < 4; ++i) { m[i] = mix[row * D + threadIdx.x + 256 * i]; s += m[i] * m[i]; }
    const float r1 = rsqrtf(block_sum256(s, red) * (1.f / D) + EPS);
    float s2 = 0.f;
#pragma unroll
    for (int i = 0; i < 4; ++i) { const int c = threadIdx.x + 256 * i; xv[i] = x[row * D + c] + m[i] * r1 * g1[c]; s2 += xv[i] * xv[i]; x1[row * D + c] = xv[i]; }
    const float r2 = rsqrtf(block_sum256(s2, red) * (1.f / D) + EPS);
#pragma unroll
    for (int i = 0; i < 4; ++i) { const int c = threadIdx.x + 256 * i; h2[row * D + c] = xv[i] * r2 * g2[c]; }
}
__global__ void __launch_bounds__(256) k_res_norm(const float* x1, const float* __restrict__ dn, const float* __restrict__ g, float* out) {
    __shared__ float red[4];
    const size_t row = blockIdx.x;
    float m[4]; float s = 0.f;
#pragma unroll
    for (int i = 0; i < 4; ++i) { m[i] = dn[row * D + threadIdx.x + 256 * i]; s += m[i] * m[i]; }
    const float r = rsqrtf(block_sum256(s, red) * (1.f / D) + EPS);
#pragma unroll
    for (int i = 0; i < 4; ++i) { const int c = threadIdx.x + 256 * i; out[row * D + c] = x1[row * D + c] + m[i] * r * g[c]; }
}
}

extern "C" void kernel_launch(void* const* d_in, const int* in_sizes, int n_in, void* d_out, int out_size, void* d_ws, size_t ws_size, hipStream_t stream) {
    const float* x = (const float*)d_in[0];
    const float* g_pre_mix = (const float*)d_in[1];
    const float* w_in = (const float*)d_in[2];
    const float* w_a_up = (const float*)d_in[3];
    const float* b_a_up = (const float*)d_in[4];
    const float* g_gla_norm = (const float*)d_in[5];
    const float* conv_w = (const float*)d_in[6];
    const float* conv_b = (const float*)d_in[7];
    const float* w_q_ml = (const float*)d_in[8];
    const float* w_k_ml = (const float*)d_in[9];
    const float* w_v_ml = (const float*)d_in[10];
    const float* w_if = (const float*)d_in[11];
    const float* b_if = (const float*)d_in[12];
    const float* ml_skip = (const float*)d_in[13];
    const float* g_ml_norm = (const float*)d_in[14];
    const float* w_pa = (const float*)d_in[15];
    const float* w_pb = (const float*)d_in[16];
    const float* w_o = (const float*)d_in[17];
    const float* g_post_mix = (const float*)d_in[18];
    const float* g_pre_mlp = (const float*)d_in[19];
    const float* w_up = (const float*)d_in[20];
    const float* w_down = (const float*)d_in[21];
    const float* g_post_mlp = (const float*)d_in[22];
    float* out = (float*)d_out;

    size_t off = 0;
    auto alloc = [&](size_t nfloat) { float* p = (float*)((char*)d_ws + off); off += ((nfloat * 4 + 255) / 256) * 256; return p; };
    float* hbuf = alloc((size_t)T * D);
    float* proj = alloc((size_t)T * DIN);
    float* cum = alloc((size_t)T * 256);
    float* sc = alloc((size_t)4 * NCH * 8192);
    float* dec = alloc((size_t)4 * NCH * 64);
    float* sprev = alloc((size_t)4 * NCH * 8192);
    float* Aa = alloc((size_t)T * 512);
    float* Ab = alloc((size_t)T * 512);
    float* xc = alloc((size_t)T * 512);
    float* qm = alloc((size_t)T * 512);
    float* km = alloc((size_t)T * 512);
    float* vm = alloc((size_t)T * 512);
    float* li = alloc((size_t)T * 4);
    float* lf = alloc((size_t)T * 4);
    float* fcum = alloc((size_t)T * 4);
    float* flast = alloc(4 * NCH);
    float* mloc = alloc(4 * NCH);
    float* mprev = alloc(4 * NCH);
    float* cc = alloc((size_t)4 * NCH * 16384);
    float* ncn = alloc((size_t)4 * NCH * 128);
    float* cprev = alloc((size_t)4 * NCH * 16384);
    float* nprev = alloc((size_t)4 * NCH * 128);
    float* ya = alloc((size_t)T * D);
    float* yb = alloc((size_t)T * D);
    float* mix = alloc((size_t)T * D);
    float* h2 = alloc((size_t)T * D);
    float* ubuf = alloc((size_t)T * FF);
    float* dn = alloc((size_t)T * D);
    if (off > ws_size) { fprintf(stderr, "workspace too small: need %zu have %zu\n", off, ws_size); return; }

    for (int b = 0; b < NB; ++b) {
        const float* xb = x + (size_t)b * T * D;
        float* ob = out + (size_t)b * T * D;
        k_rmsnorm<<<T, 256, 0, stream>>>(xb, g_pre_mix, hbuf);
        k_gemm<<<dim3((DIN + 63) / 64, T / 64), 256, 0, stream>>>(hbuf, D, w_in, DIN, proj, DIN, DIN, D, 0);
        k_gla_cum<<<NCH, 256, 0, stream>>>(proj, w_a_up, b_a_up, cum);
        k_gla_state<<<dim3(NCH, 4), 256, 0, stream>>>(proj, cum, sc, dec);
        k_gla_scan<<<4 * 8192 / 256, 256, 0, stream>>>(sc, dec, sprev);
        k_gla_out<<<dim3(NCH, 4), 256, 0, stream>>>(proj, cum, sprev, g_gla_norm, Aa);
        k_ml_pre<<<T, 128, 0, stream>>>(proj, conv_w, conv_b, w_q_ml, w_k_ml, w_v_ml, xc, qm, km, vm);
        k_ml_gates<<<T / 4, 256, 0, stream>>>(qm, km, vm, w_if, b_if, li, lf);
        k_ml_cum<<<1, 128, 0, stream>>>(li, lf, fcum, flast, mloc);
        k_ml_state<<<dim3(NCH, 4), 256, 0, stream>>>(km, vm, li, fcum, flast, mloc, cc, ncn);
        k_ml_scan<<<4 * 16384 / 256, 256, 0, stream>>>(cc, ncn, flast, mloc, cprev, nprev, mprev);
        k_ml_out<<<dim3(NCH, 4), 256, 0, stream>>>(proj, qm, km, vm, xc, li, fcum, cprev, nprev, mprev, ml_skip, g_ml_norm, Ab);
        k_gemm<<<dim3(D / 64, T / 64), 256, 0, stream>>>(Aa, 512, w_pa, D, ya, D, D, 512, 0);
        k_gemm<<<dim3(D / 64, T / 64), 256, 0, stream>>>(Ab, 512, w_pb, D, yb, D, D, 512, 0);
        k_merge<<<T, 256, 0, stream>>>(proj, ya, yb);
        k_gemm<<<dim3(D / 64, T / 64), 256, 0, stream>>>(ya, D, w_o, D, mix, D, D, D, 0);
        k_res_norm2<<<T, 256, 0, stream>>>(xb, mix, g_post_mix, g_pre_mlp, ob, h2);
        k_gemm<<<dim3(FF / 64, T / 64), 256, 0, stream>>>(h2, D, w_up, FF, ubuf, FF, FF, D, 1);
        k_gemm<<<dim3(D / 64, T / 64), 256, 0, stream>>>(ubuf, FF, w_down, D, dn, D, D, FF, 0);
        k_res_norm<<<T, 256, 0, stream>>>(ob, dn, g_post_mlp, ob);
    }
}
```
